# Optimizing an MI355X kernel written in HIP

```python
import math
import jax, jax.numpy as jnp
from jax import lax
import numpy as np

D_MODEL = 1024
BATCH = 4
SEQ = 4096
DEPTH = 2

CHUNK = 64
HEAD_DIM = 64
N_A_LAYERS = DEPTH // 2
N_B_LAYERS = DEPTH - N_A_LAYERS
RMS_EPS = 1e-6
A_HEADS = D_MODEL // HEAD_DIM
A_WIDTH = A_HEADS * HEAD_DIM
A_LEFT_CHUNKS = 8
A_BAND = (A_LEFT_CHUNKS + 1) * CHUNK
A_REL_CLIP = 256
B_Q_HEADS = D_MODEL // HEAD_DIM
B_KV_HEADS = max(1, B_Q_HEADS // 8)
B_GROUP = B_Q_HEADS // B_KV_HEADS
B_WIDTH = B_Q_HEADS * HEAD_DIM
B_KV_WIDTH = B_KV_HEADS * HEAD_DIM
B_WINDOW = 128
B_LEFT_CHUNKS = (B_WINDOW - 1) // CHUNK + 1
B_BAND = (B_LEFT_CHUNKS + 1) * CHUNK
T5_BUCKETS = 32
T5_MAX_DIST = 128

kernel_name = "yoco_chunk_relbias_swa_sink_hybrid"


def rmsnorm(x, g):
    xf = x.astype(jnp.float32)
    y = xf * lax.rsqrt(jnp.mean(xf * xf, axis=-1, keepdims=True) + RMS_EPS)
    return (y * g.astype(jnp.float32)).astype(x.dtype)


def t5_bucket(rel):
    nb = T5_BUCKETS // 2
    max_exact = nb // 2
    ret = jnp.where(rel > 0, nb, 0)
    n = jnp.abs(rel)
    nf = jnp.maximum(n, 1).astype(jnp.float32)
    large = max_exact + (jnp.log(nf / max_exact) / math.log(T5_MAX_DIST / max_exact)
                         * (nb - max_exact)).astype(jnp.int32)
    large = jnp.minimum(large, nb - 1)
    return ret + jnp.where(n < max_exact, n, large)


def mixer_a(x, w_in, rel_bias, w_out):
    b, s, _ = x.shape
    nc = s // CHUNK
    pad = A_LEFT_CHUNKS * CHUNK
    q, k, v, g = jnp.split(x @ w_in, 4, axis=-1)
    q = q.reshape(b, nc, CHUNK, A_HEADS, HEAD_DIM)
    k = jnp.pad(k.reshape(b, s, A_HEADS, HEAD_DIM), ((0, 0), (pad, 0), (0, 0), (0, 0)))
    v = jnp.pad(v.reshape(b, s, A_HEADS, HEAD_DIM), ((0, 0), (pad, 0), (0, 0), (0, 0)))
    dist = jnp.arange(CHUNK)[:, None] + pad - jnp.arange(A_BAND)[None, :]
    idx = jnp.clip(dist, -A_REL_CLIP, A_REL_CLIP) + A_REL_CLIP
    bias = jnp.transpose(rel_bias[idx], (2, 0, 1)).astype(jnp.float32)
    scale = HEAD_DIM ** -0.5

    def one_chunk(args):
        qc, c = args
        kc = lax.dynamic_slice_in_dim(k, c * CHUNK, A_BAND, axis=1)
        vc = lax.dynamic_slice_in_dim(v, c * CHUNK, A_BAND, axis=1)
        logits = jnp.einsum('bqhd,bkhd->bhqk', qc, kc).astype(jnp.float32) * scale + bias
        key_pos = c * CHUNK - pad + jnp.arange(A_BAND)
        logits = jnp.where((key_pos >= 0)[None, None, None, :], logits, -jnp.inf)
        p = jax.nn.softmax(logits, axis=-1).astype(vc.dtype)
        return jnp.einsum('bhqk,bkhd->bqhd', p, vc)

    out = lax.map(one_chunk, (jnp.moveaxis(q, 1, 0), jnp.arange(nc)))
    out = jnp.moveaxis(out, 0, 1).reshape(b, s, A_WIDTH)
    return (out * jax.nn.silu(g)) @ w_out


def mixer_b(x, w_in, sinks, t5_table, k_sh, v_sh, w_out):
    b, s, _ = x.shape
    nc = s // CHUNK
    pad = B_LEFT_CHUNKS * CHUNK
    q, g = jnp.split(x @ w_in, 2, axis=-1)
    q = q.reshape(b, nc, CHUNK, B_KV_HEADS, B_GROUP, HEAD_DIM)
    kp = jnp.pad(k_sh, ((0, 0), (pad, 0), (0, 0), (0, 0)))
    vp = jnp.pad(v_sh, ((0, 0), (pad, 0), (0, 0), (0, 0)))
    band_idx = jnp.arange(nc)[:, None] * CHUNK + jnp.arange(B_BAND)[None, :]
    kb = kp[:, band_idx]
    vb = vp[:, band_idx]
    rel = jnp.arange(B_BAND)[None, :] - pad - jnp.arange(CHUNK)[:, None]
    bias = jnp.transpose(t5_table[t5_bucket(rel)], (2, 0, 1)).astype(jnp.float32)
    bias = bias.reshape(B_KV_HEADS, B_GROUP, 1, CHUNK, B_BAND)
    scale = HEAD_DIM ** -0.5
    logits = jnp.einsum('bcqhgd,bckhd->bhgcqk', q, kb).astype(jnp.float32) * scale + bias
    key_pos = band_idx - pad
    logits = jnp.where((key_pos >= 0)[:, None, :], logits, -jnp.inf)
    sink = jnp.broadcast_to(
        sinks.astype(jnp.float32).reshape(1, B_KV_HEADS, B_GROUP, 1, 1, 1),
        logits.shape[:-1] + (1,))
    p = jax.nn.softmax(jnp.concatenate([logits, sink], axis=-1), axis=-1)[..., :-1]
    out = jnp.einsum('bhgcqk,bckhd->bcqhgd', p.astype(vb.dtype), vb)
    out = out.reshape(b, s, B_WIDTH)
    return (out * jax.nn.silu(g)) @ w_out


def setup_inputs(seed: int = 0) -> dict:
    key = jax.random.key(seed)
    ks = jax.random.split(key, 13)
    f32 = jnp.float32
    nrm = lambda k, shape, sc: (jax.random.normal(k, shape, f32) * sc).astype(f32)
    return {
        "x": nrm(ks[0], (BATCH, SEQ, D_MODEL), 1.0),
        "a_norm": 1.0 + nrm(ks[1], (N_A_LAYERS, D_MODEL), 0.02),
        "a_w_in": nrm(ks[2], (N_A_LAYERS, D_MODEL, 4 * A_WIDTH), D_MODEL ** -0.5),
        "a_rel_bias": nrm(ks[3], (N_A_LAYERS, 2 * A_REL_CLIP + 1, A_HEADS), 0.3),
        "a_w_out": nrm(ks[4], (N_A_LAYERS, A_WIDTH, D_MODEL), A_WIDTH ** -0.5),
        "kv_norm": 1.0 + nrm(ks[5], (D_MODEL,), 0.02),
        "kv_w": nrm(ks[6], (D_MODEL, 2 * B_KV_WIDTH), D_MODEL ** -0.5),
        "t5_bias": nrm(ks[7], (T5_BUCKETS, B_Q_HEADS), 0.3),
        "b_norm": 1.0 + nrm(ks[8], (N_B_LAYERS, D_MODEL), 0.02),
        "b_w_in": nrm(ks[9], (N_B_LAYERS, D_MODEL, 2 * B_WIDTH), D_MODEL ** -0.5),
        "b_sinks": nrm(ks[10], (N_B_LAYERS, B_Q_HEADS), 0.5),
        "b_w_out": nrm(ks[11], (N_B_LAYERS, B_WIDTH, D_MODEL), B_WIDTH ** -0.5),
        "final_norm": 1.0 + nrm(ks[12], (D_MODEL,), 0.02),
    }


def reference(x, a_norm, a_w_in, a_rel_bias, a_w_out, kv_norm, kv_w, t5_bias,
              b_norm, b_w_in, b_sinks, b_w_out, final_norm):
    h = x
    k_sh = v_sh = None
    for layer in range(DEPTH):
        if layer == N_A_LAYERS:
            kv = rmsnorm(h, kv_norm) @ kv_w
            k_sh, v_sh = jnp.split(kv, 2, axis=-1)
            k_sh = k_sh.reshape(h.shape[0], h.shape[1], B_KV_HEADS, HEAD_DIM)
            v_sh = v_sh.reshape(h.shape[0], h.shape[1], B_KV_HEADS, HEAD_DIM)
        if layer < N_A_LAYERS:
            h = h + mixer_a(rmsnorm(h, a_norm[layer]), a_w_in[layer],
                            a_rel_bias[layer], a_w_out[layer])
        else:
            j = layer - N_A_LAYERS
            h = h + mixer_b(rmsnorm(h, b_norm[j]), b_w_in[j], b_sinks[j], t5_bias,
                            k_sh, v_sh, b_w_out[j])
    return rmsnorm(h, final_norm)
```

```cpp
#include <hip/hip_runtime.h>
#include <hip/hip_cooperative_groups.h>
#include <cstdio>
#include <cstdint>
namespace cg = cooperative_groups;

typedef unsigned short bf16_t;
typedef short bf16x8 __attribute__((ext_vector_type(8)));
typedef float f32x16 __attribute__((ext_vector_type(16)));
typedef float f32x4 __attribute__((ext_vector_type(4)));
typedef unsigned u32x4 __attribute__((ext_vector_type(4)));
typedef unsigned u32x2 __attribute__((ext_vector_type(2)));

constexpr int BATCH = 4, SEQ = 4096, D = 1024, M = BATCH * SEQ;
constexpr float LOG2E = 1.4426950408889634f;
constexpr float C2 = 0.125f * LOG2E;
constexpr float EPS = 1e-6f;
constexpr size_t MiB = 1u << 20;
constexpr size_t WS_RELB = 1 * MiB;
constexpr size_t WS_T5B = WS_RELB + 64 * 1024;
constexpr size_t WS_SINK = WS_T5B + 32 * 1024;
constexpr size_t WS_WA = 2 * MiB;
constexpr size_t WS_WOA = 10 * MiB;
constexpr size_t WS_WKVB = 12 * MiB;
constexpr size_t WS_WOB = 17 * MiB;
constexpr size_t WS_XN = 20 * MiB;
constexpr size_t WS_Q = 52 * MiB, WS_K = 84 * MiB, WS_V = 116 * MiB, WS_G = 148 * MiB;
constexpr size_t WS_KSH = 180 * MiB, WS_VSH = 184 * MiB;
constexpr size_t WS_END = 188 * MiB;

struct Params {
    const float *x, *a_norm, *a_w_in, *a_rel_bias, *a_w_out, *kv_norm, *kv_w, *t5_bias, *b_norm, *b_w_in, *b_sinks, *b_w_out, *final_norm;
    float* out; unsigned char* ws;
};

__device__ __forceinline__ unsigned f2bf(float f) { unsigned u = __float_as_uint(f); return (u + 0x7fffu + ((u >> 16) & 1u)) >> 16; }
__device__ __forceinline__ unsigned pk2(float lo, float hi) { return f2bf(lo) | (f2bf(hi) << 16); }
__device__ __forceinline__ float bf2f(bf16_t b) { return __uint_as_float(((unsigned)b) << 16); }
__device__ __forceinline__ float wave_sum(float v) {
#pragma unroll
    for (int o = 1; o < 64; o <<= 1) v += __shfl_xor(v, o);
    return v;
}
__device__ __forceinline__ float silu_f(float v) { return v / (1.0f + __expf(-v)); }

__device__ __forceinline__ void transpose_item(const float* W, const float* gain, int K, int N, bf16_t* WT, int row_off, float* scr, int item, int lane) {
    const int nblk = N / 32, kb = item / nblk, nb = item % nblk, k0 = 64 * kb, n0 = 32 * nb;
#pragma unroll 8
    for (int i = 0; i < 32; ++i) { const int kk = 2 * i + (lane >> 5); const float g = gain ? gain[k0 + kk] : 1.0f; scr[kk * 33 + (lane & 31)] = W[(size_t)(k0 + kk) * N + n0 + (lane & 31)] * g; }
    asm volatile("s_waitcnt lgkmcnt(0)" ::: "memory");
    const int c = lane & 7;
#pragma unroll
    for (int j = 0; j < 4; ++j) { const int n = (lane >> 3) + 8 * j; const float* s = scr + (8 * c) * 33 + n;
        u32x4 o; o.x = pk2(s[0 * 33], s[1 * 33]); o.y = pk2(s[2 * 33], s[3 * 33]); o.z = pk2(s[4 * 33], s[5 * 33]); o.w = pk2(s[6 * 33], s[7 * 33]);
        *(u32x4*)(WT + (size_t)(row_off + n0 + n) * K + k0 + 8 * c) = o; }
    asm volatile("s_waitcnt lgkmcnt(0)" ::: "memory");
}

__device__ __forceinline__ void norm_row_bf16(const float* xrow, bf16_t* orow, int lane) {
    const f32x4* xr = (const f32x4*)xrow + lane;
    f32x4 v[4]; float s = 0.f;
#pragma unroll
    for (int j = 0; j < 4; ++j) { v[j] = xr[64 * j]; s += (v[j].x * v[j].x + v[j].y * v[j].y) + (v[j].z * v[j].z + v[j].w * v[j].w); }
    const float rstd = 1.0f / sqrtf(wave_sum(s) * (1.0f / D) + EPS);
    u32x2* o8 = (u32x2*)orow + lane;
#pragma unroll
    for (int j = 0; j < 4; ++j) { u32x2 w; w.x = pk2(v[j].x * rstd, v[j].y * rstd); w.y = pk2(v[j].z * rstd, v[j].w * rstd); o8[64 * j] = w; }
}

__device__ __forceinline__ int t5_bucket(int rel) {
    const int n = rel < 0 ? -rel : rel;
    int v;
    if (n < 8) v = n;
    else if (n < 12) v = 8; else if (n < 16) v = 9; else if (n < 23) v = 10; else if (n < 32) v = 11;
    else if (n < 46) v = 12; else if (n < 64) v = 13; else if (n < 91) v = 14; else v = 15;
    return (rel > 0 ? 16 : 0) + v;
}

template <class Epi>
__device__ __forceinline__ void gemm_simple(const bf16_t* __restrict__ A, const bf16_t* __restrict__ Bt, int Mrows, int N, int K, const Epi& epi, unsigned char* lds) {
    bf16_t* sA = (bf16_t*)lds; bf16_t* sB = sA + 128 * 40;
    const int tid = threadIdx.x, lane = tid & 63, wid = tid >> 6, r32 = lane & 31, hi = lane >> 5;
    const int wr = wid >> 1, wc = wid & 1;
    const int nN = N / 128, ntiles = (Mrows / 128) * nN;
    for (int t = blockIdx.x; t < ntiles; t += gridDim.x) {
        const int tm = t / nN, tn = t % nN, m0 = tm * 128, n0 = tn * 128;
        f32x16 acc[2][2];
#pragma unroll
        for (int i = 0; i < 2; ++i)
#pragma unroll
            for (int j = 0; j < 2; ++j)
#pragma unroll
                for (int r = 0; r < 16; ++r) acc[i][j][r] = 0.f;
        for (int k0 = 0; k0 < K; k0 += 32) {
            u32x4 ra[2], rb[2];
#pragma unroll
            for (int i = 0; i < 2; ++i) { const int idx = tid + i * 256, row = idx >> 2, seg = idx & 3;
                ra[i] = *(const u32x4*)(A + (size_t)(m0 + row) * K + k0 + seg * 8);
                rb[i] = *(const u32x4*)(Bt + (size_t)(n0 + row) * K + k0 + seg * 8); }
            __syncthreads();
#pragma unroll
            for (int i = 0; i < 2; ++i) { const int idx = tid + i * 256, row = idx >> 2, seg = idx & 3;
                *(u32x4*)(sA + row * 40 + seg * 8) = ra[i]; *(u32x4*)(sB + row * 40 + seg * 8) = rb[i]; }
            __syncthreads();
#pragma unroll
            for (int kk = 0; kk < 2; ++kk) {
                bf16x8 a[2], b[2];
#pragma unroll
                for (int i = 0; i < 2; ++i) a[i] = *(const bf16x8*)(sA + (wr * 64 + i * 32 + r32) * 40 + kk * 16 + hi * 8);
#pragma unroll
                for (int j = 0; j < 2; ++j) b[j] = *(const bf16x8*)(sB + (wc * 64 + j * 32 + r32) * 40 + kk * 16 + hi * 8);
#pragma unroll
                for (int i = 0; i < 2; ++i)
#pragma unroll
                    for (int j = 0; j < 2; ++j) acc[i][j] = __builtin_amdgcn_mfma_f32_32x32x16_bf16(a[i], b[j], acc[i][j], 0, 0, 0);
            }
        }
#pragma unroll
        for (int i = 0; i < 2; ++i)
#pragma unroll
            for (int j = 0; j < 2; ++j)
#pragma unroll
                for (int r = 0; r < 16; ++r) {
                    const int row = m0 + wr * 64 + i * 32 + (r & 3) + 8 * (r >> 2) + 4 * hi, col = n0 + wc * 64 + j * 32 + r32;
                    epi(row, col, acc[i][j][r]);
                }
    }
}

struct EpiInA {
    bf16_t *Q, *K, *V, *G;
    __device__ __forceinline__ void operator()(int row, int col, float v) const {
        const int part = col >> 10, c = col & 1023; const size_t o = (size_t)row * 1024 + c;
        if (part == 0) Q[o] = (bf16_t)f2bf(v * C2);
        else if (part == 1) K[o] = (bf16_t)f2bf(v);
        else if (part == 2) V[o] = (bf16_t)f2bf(v);
        else G[o] = (bf16_t)f2bf(silu_f(v));
    }
};
struct EpiInB {
    bf16_t *Ksh, *Vsh, *Q, *G;
    __device__ __forceinline__ void operator()(int row, int col, float v) const {
        if (col < 128) Ksh[(size_t)row * 128 + col] = (bf16_t)f2bf(v);
        else if (col < 256) Vsh[(size_t)row * 128 + col - 128] = (bf16_t)f2bf(v);
        else if (col < 1280) Q[(size_t)row * 1024 + col - 256] = (bf16_t)f2bf(v * C2);
        else G[(size_t)row * 1024 + col - 1280] = (bf16_t)f2bf(silu_f(v));
    }
};
struct EpiRes {
    const float* base; float* out;
    __device__ __forceinline__ void operator()(int row, int col, float v) const { const size_t o = (size_t)row * 1024 + col; out[o] = base[o] + v; }
};

template <bool LB>
__device__ __forceinline__ void attn_simple(const bf16_t* Q, const bf16_t* __restrict__ Kb, const bf16_t* __restrict__ Vb, const bf16_t* __restrict__ G, bf16_t* O,
                                            const float* __restrict__ btab, const float* __restrict__ sink2, float* wsf) {
    constexpr int NT = LB ? 3 : 9, LEFT = NT - 1, KS = LB ? 128 : 1024;
    const int tid = threadIdx.x, lane = tid & 63, wid = tid >> 6, r32 = lane & 31, hi = lane >> 5;
    const int gw = blockIdx.x * 4 + wid, NGW = gridDim.x * 4;
    for (int u = gw; u < 8192; u += NGW) {
        const int half = u & 1, c = (u >> 1) & 63, h = (u >> 7) & 15, b = u >> 11;
        const int kvh = LB ? (h >> 3) : h;
        const int m0 = b * SEQ + c * 64 + half * 32;
        bf16x8 qf[4];
#pragma unroll
        for (int d0 = 0; d0 < 4; ++d0) qf[d0] = *(const bf16x8*)(Q + (size_t)(m0 + r32) * 1024 + h * 64 + d0 * 16 + hi * 8);
        float m = LB ? sink2[h] : -1e30f;
        float l = (LB && hi == 0) ? 1.f : 0.f;
        f32x16 o[2];
#pragma unroll
        for (int r = 0; r < 16; ++r) { o[0][r] = 0.f; o[1][r] = 0.f; }
        const int qpos = c * 64 + half * 32 + r32;
        for (int kb = 0; kb < NT * 2; ++kb) {
            const int ck = c - LEFT + (kb >> 1);
            if (ck < 0) continue;
            const int krow0 = b * SEQ + ck * 64 + (kb & 1) * 32;
            f32x16 s;
#pragma unroll
            for (int r = 0; r < 16; ++r) s[r] = 0.f;
#pragma unroll
            for (int d0 = 0; d0 < 4; ++d0) {
                const bf16x8 kf = *(const bf16x8*)(Kb + (size_t)(krow0 + r32) * KS + kvh * 64 + d0 * 16 + hi * 8);
                s = __builtin_amdgcn_mfma_f32_32x32x16_bf16(kf, qf[d0], s, 0, 0, 0);
            }
            const int kbase = ck * 64 + (kb & 1) * 32 + 4 * hi;
#pragma unroll
            for (int r = 0; r < 16; ++r) {
                const int kpos = kbase + (r & 3) + 8 * (r >> 2);
                if (LB) { s[r] += btab[h * 256 + (kpos - qpos) + 191]; }
                else { int dist = qpos - kpos; dist = dist < -256 ? -256 : (dist > 256 ? 256 : dist); s[r] += btab[h * 520 + dist + 256]; }
            }
            float bm = s[0];
#pragma unroll
            for (int r = 1; r < 16; ++r) bm = fmaxf(bm, s[r]);
            bm = fmaxf(bm, __shfl_xor(bm, 32));
            const float mn = fmaxf(m, bm), alpha = __builtin_amdgcn_exp2f(m - mn); m = mn;
            float ps = 0.f;
#pragma unroll
            for (int r = 0; r < 16; ++r) { s[r] = __builtin_amdgcn_exp2f(s[r] - mn); ps += s[r]; }
            l = l * alpha + ps;
            if (hi == 0) wsf[r32] = alpha;
            asm volatile("s_waitcnt lgkmcnt(0)" ::: "memory");
#pragma unroll
            for (int r = 0; r < 16; ++r) { const float a = wsf[(r & 3) + 8 * (r >> 2) + 4 * hi]; o[0][r] *= a; o[1][r] *= a; }
            asm volatile("s_waitcnt lgkmcnt(0)" ::: "memory");
#pragma unroll
            for (int s2 = 0; s2 < 2; ++s2) {
                u32x4 pw; pw.x = pk2(s[8 * s2 + 0], s[8 * s2 + 1]); pw.y = pk2(s[8 * s2 + 2], s[8 * s2 + 3]); pw.z = pk2(s[8 * s2 + 4], s[8 * s2 + 5]); pw.w = pk2(s[8 * s2 + 6], s[8 * s2 + 7]);
                const bf16x8 pa = __builtin_bit_cast(bf16x8, pw);
#pragma unroll
                for (int db = 0; db < 2; ++db) {
                    bf16x8 vf;
#pragma unroll
                    for (int j = 0; j < 8; ++j) { const int key = 16 * s2 + 8 * (j >> 2) + 4 * hi + (j & 3);
                        vf[j] = (short)Vb[(size_t)(krow0 + key) * KS + kvh * 64 + db * 32 + r32]; }
                    o[db] = __builtin_amdgcn_mfma_f32_32x32x16_bf16(pa, vf, o[db], 0, 0, 0);
                }
            }
        }
        l += __shfl_xor(l, 32);
        if (hi == 0) wsf[r32] = 1.0f / l;
        asm volatile("s_waitcnt lgkmcnt(0)" ::: "memory");
#pragma unroll
        for (int r = 0; r < 16; ++r) {
            const int row = (r & 3) + 8 * (r >> 2) + 4 * hi; const float a = wsf[row];
#pragma unroll
            for (int db = 0; db < 2; ++db) { const size_t off = (size_t)(m0 + row) * 1024 + h * 64 + db * 32 + r32;
                O[off] = (bf16_t)f2bf(o[db][r] * a * bf2f(G[off])); }
        }
        asm volatile("s_waitcnt lgkmcnt(0)" ::: "memory");
    }
}

__global__ void __launch_bounds__(256, 2) fwd_megakernel(Params p) {
    cg::grid_group grid = cg::this_grid();
    __shared__ __attribute__((aligned(16))) unsigned char lds[4 * 8448];
    const int tid = threadIdx.x, lane = tid & 63, wid = tid >> 6;
    const int gw = blockIdx.x * 4 + wid, NGW = gridDim.x * 4;
    unsigned char* ws = p.ws;
    float* relb = (float*)(ws + WS_RELB); float* t5b = (float*)(ws + WS_T5B); float* sink2 = (float*)(ws + WS_SINK);
    bf16_t* WaT = (bf16_t*)(ws + WS_WA); bf16_t* WoAT = (bf16_t*)(ws + WS_WOA); bf16_t* WkvbT = (bf16_t*)(ws + WS_WKVB); bf16_t* WoBT = (bf16_t*)(ws + WS_WOB);
    bf16_t* XN = (bf16_t*)(ws + WS_XN); bf16_t* Qb = (bf16_t*)(ws + WS_Q); bf16_t* Kb = (bf16_t*)(ws + WS_K); bf16_t* Vb = (bf16_t*)(ws + WS_V); bf16_t* Gb = (bf16_t*)(ws + WS_G);
    bf16_t* Ksh = (bf16_t*)(ws + WS_KSH); bf16_t* Vsh = (bf16_t*)(ws + WS_VSH);
    float* wsf = (float*)lds + wid * 64;

    {
        float* scr = (float*)(lds + wid * 8448);
        constexpr int I_A = 16 * 128, I_O = 16 * 32, I_KV = 16 * 8, I_B = 16 * 64;
        constexpr int NIT = I_A + I_O + I_KV + I_B + I_O;
        for (int it = gw; it < NIT; it += NGW) {
            int r = it;
            if (r < I_A) { transpose_item(p.a_w_in, p.a_norm, 1024, 4096, WaT, 0, scr, r, lane); continue; } r -= I_A;
            if (r < I_O) { transpose_item(p.a_w_out, nullptr, 1024, 1024, WoAT, 0, scr, r, lane); continue; } r -= I_O;
            if (r < I_KV) { transpose_item(p.kv_w, p.kv_norm, 1024, 256, WkvbT, 0, scr, r, lane); continue; } r -= I_KV;
            if (r < I_B) { transpose_item(p.b_w_in, p.b_norm, 1024, 2048, WkvbT, 256, scr, r, lane); continue; } r -= I_B;
            transpose_item(p.b_w_out, nullptr, 1024, 1024, WoBT, 0, scr, r, lane);
        }
        const int gt = blockIdx.x * 256 + tid, NGT = gridDim.x * 256;
        for (int i = gt; i < 16 * 513; i += NGT) { const int h = i / 513, j = i % 513; relb[h * 520 + j] = p.a_rel_bias[j * 16 + h] * LOG2E; }
        for (int i = gt; i < 16 * 255; i += NGT) { const int h = i / 255, j = i % 255; t5b[h * 256 + j] = p.t5_bias[t5_bucket(j - 191) * 16 + h] * LOG2E; }
        if (gt < 16) sink2[gt] = p.b_sinks[gt] * LOG2E;
        for (int m = gw; m < M; m += NGW) norm_row_bf16(p.x + (size_t)m * D, XN + (size_t)m * D, lane);
    }
    grid.sync();
    { EpiInA e{Qb, Kb, Vb, Gb}; gemm_simple(XN, WaT, M, 4096, 1024, e, lds); }
    grid.sync();
    attn_simple<false>(Qb, Kb, Vb, Gb, Qb, relb, sink2, wsf);
    grid.sync();
    { EpiRes e{p.x, p.out}; gemm_simple(Qb, WoAT, M, 1024, 1024, e, lds); }
    grid.sync();
    for (int m = gw; m < M; m += NGW) norm_row_bf16(p.out + (size_t)m * D, XN + (size_t)m * D, lane);
    grid.sync();
    { EpiInB e{Ksh, Vsh, Kb, Vb}; gemm_simple(XN, WkvbT, M, 2304, 1024, e, lds); }
    grid.sync();
    attn_simple<true>(Kb, Ksh, Vsh, Vb, Kb, t5b, sink2, wsf);
    grid.sync();
    { EpiRes e{p.out, p.out}; gemm_simple(Kb, WoBT, M, 1024, 1024, e, lds); }
    grid.sync();
    for (int m = gw; m < M; m += NGW) {
        f32x4* xr = (f32x4*)(p.out + (size_t)m * D) + lane; const f32x4* gr = (const f32x4*)p.final_norm + lane;
        f32x4 v[4]; float s = 0.f;
#pragma unroll
        for (int j = 0; j < 4; ++j) { v[j] = xr[64 * j]; s += (v[j].x * v[j].x + v[j].y * v[j].y) + (v[j].z * v[j].z + v[j].w * v[j].w); }
        const float rstd = 1.0f / sqrtf(wave_sum(s) * (1.0f / D) + EPS);
#pragma unroll
        for (int j = 0; j < 4; ++j) { const f32x4 g = gr[64 * j]; xr[64 * j] = v[j] * rstd * g; }
    }
}

extern "C" void kernel_launch(void* const* d_in, const int* in_sizes, int n_in, void* d_out, int out_size, void* d_ws, size_t ws_size, hipStream_t stream) {
    static int grid_blocks = 0;
    if (grid_blocks == 0) {
        if (n_in != 13 || out_size != M * D || ws_size < WS_END) { fprintf(stderr, "kernel_launch: unexpected shapes n_in %d out %d ws %zu\n", n_in, out_size, ws_size); grid_blocks = -1; return; }
        int dev = 0, cus = 0, per_cu = 0;
        hipGetDevice(&dev);
        hipDeviceGetAttribute(&cus, hipDeviceAttributeMultiprocessorCount, dev);
        hipOccupancyMaxActiveBlocksPerMultiprocessor(&per_cu, (const void*)fwd_megakernel, 256, 0);
        if (per_cu > 2) per_cu = 2;
        if (per_cu < 1) per_cu = 1;
        grid_blocks = cus * per_cu;
    }
    if (grid_blocks < 0) return;
    Params p{};
    p.x = (const float*)d_in[0]; p.a_norm = (const float*)d_in[1]; p.a_w_in = (const float*)d_in[2]; p.a_rel_bias = (const float*)d_in[3];
    p.a_w_out = (const float*)d_in[4]; p.kv_norm = (const float*)d_in[5]; p.kv_w = (const float*)d_in[6]; p.t5_bias = (const float*)d_in[7];
    p.b_norm = (const float*)d_in[8]; p.b_w_in = (const float*)d_in[9]; p.b_sinks = (const float*)d_in[10]; p.b_w_out = (const float*)d_in[11];
    p.final_norm = (const float*)d_in[12]; p.out = (float*)d_out; p.ws = (unsigned char*)d_ws;
    void* args[] = {&p};
    hipError_t e = hipLaunchCooperativeKernel((const void*)fwd_megakernel, dim3(grid_blocks), dim3(256), args, 0, stream);
    if (e != hipSuccess) fprintf(stderr, "cooperative launch failed: %s (grid %d)\n", hipGetErrorString(e), grid_blocks);
}
```

```cpp
#include <hip/hip_runtime.h>
#include <cstdio>
#include <cstdint>

typedef unsigned short bf16_t;
typedef short bf16x8 __attribute__((ext_vector_type(8)));
typedef float f32x16 __attribute__((ext_vector_type(16)));
typedef float f32x4 __attribute__((ext_vector_type(4)));
typedef unsigned u32x4 __attribute__((ext_vector_type(4)));
typedef unsigned u32x2 __attribute__((ext_vector_type(2)));
#define LAS __attribute__((address_space(3)))

constexpr int BATCH = 4, SEQ = 4096, D = 1024, M = BATCH * SEQ;
constexpr int NWAVES = 8;
constexpr float LOG2E = 1.4426950408889634f;
constexpr float C2 = 0.125f * LOG2E;
constexpr float EPS = 1e-6f;
constexpr size_t MiB = 1u << 20;
constexpr size_t WS_CTL = 0, CTL_ZERO_BYTES = 64 * 1024;
constexpr int CW_BAR = 4096;
constexpr size_t WS_RELB = 1 * MiB;
constexpr size_t WS_T5B = WS_RELB + 64 * 1024;
constexpr size_t WS_SINK = WS_T5B + 32 * 1024;
constexpr size_t WS_WA = 2 * MiB;
constexpr size_t WS_WOA = 10 * MiB;
constexpr size_t WS_WKVB = 12 * MiB;
constexpr size_t WS_WOB = 17 * MiB;
constexpr size_t WS_XN = 20 * MiB;
constexpr size_t WS_Q = 52 * MiB, WS_K = 84 * MiB, WS_V = 116 * MiB, WS_G = 148 * MiB;
constexpr size_t WS_KSH = 180 * MiB, WS_VSH = 184 * MiB;
constexpr size_t WS_END = 188 * MiB;
constexpr int RING_BYTES = 131072, LDSCTL_OFF = RING_BYTES, MISC_OFF = LDSCTL_OFF + 320, LDS_BYTES = 147456;

struct Params {
    const float *x, *a_norm, *a_w_in, *a_rel_bias, *a_w_out, *kv_norm, *kv_w, *t5_bias, *b_norm, *b_w_in, *b_sinks, *b_w_out, *final_norm;
    float* out; unsigned char* ws;
};

__device__ __forceinline__ unsigned f2bf(float f) { unsigned u = __float_as_uint(f); return (u + 0x7fffu + ((u >> 16) & 1u)) >> 16; }
__device__ __forceinline__ unsigned pk2(float lo, float hi) { return f2bf(lo) | (f2bf(hi) << 16); }
__device__ __forceinline__ float bf2f(bf16_t b) { return __uint_as_float(((unsigned)b) << 16); }
__device__ __forceinline__ float wave_sum(float v) {
#pragma unroll
    for (int o = 1; o < 64; o <<= 1) v += __shfl_xor(v, o);
    return v;
}
__device__ __forceinline__ float silu_f(float v) { return v * __builtin_amdgcn_rcpf(1.0f + __builtin_amdgcn_exp2f(-LOG2E * v)); }

namespace pg8 {
#define PG8_LAS __attribute__((address_space(3)))
typedef unsigned short bf16_t;
typedef short bf16x8 __attribute__((ext_vector_type(8)));
typedef float f32x4 __attribute__((ext_vector_type(4)));
typedef unsigned u32x4 __attribute__((ext_vector_type(4)));
constexpr int BM = 256, BK = 64, HALF = 128, HTB = HALF * BK * 2  , STAGE_BYTES = 8 * HTB, NXCD = 8, WGM = 8;

__host__ __device__ __forceinline__ int lds_byte(int r, int c) { const int st = (r >> 4) * 2 + (c >> 5), rr = r & 15, cc = c & 31, ob = rr * 64 + cc * 2; return st * 1024 + (ob ^ (((ob >> 9) & 1) << 5)); }
__host__ __device__ __forceinline__ void stage_rc(int b, int& R, int& C) { const int st = b / 1024, sb = b % 1024, swz = sb ^ (((sb >> 9) & 1) << 5); R = (st >> 1) * 16 + swz / 64; C = (st & 1) * 32 + (swz % 64) / 2; }
__host__ __device__ __forceinline__ int perm32(int rho) { const int n = rho >> 4, i = rho & 15; return 8 * (i >> 2) + 4 * n + (i & 3); }

struct Unit { int pm, pn; };
struct Gemm { const bf16_t* A; const bf16_t* Bt; int M, N, K; };

struct StaticOrder {
    int nM, nN, nwg, G, c;
    __host__ __device__ void init(int M, int N, int G_, int c_) { nM = M / BM; nN = N / BM; nwg = nM * nN; G = G_; c = c_; }
    __host__ __device__ bool next(int i, Unit& u) const {
        const long L = (long)i * G + c; if (L >= nwg) return false;
        int wgid = (int)L; { const int q = nwg / NXCD, r = nwg % NXCD, xcd = wgid % NXCD, off = wgid / NXCD; wgid = (xcd < r ? xcd * (q + 1) : r * (q + 1) + (xcd - r) * q) + off; }
        const int nig = WGM * nN, gid = wgid / nig, fm = gid * WGM, gsz = (nM - fm) < WGM ? (nM - fm) : WGM;
        u.pm = fm + ((wgid % nig) % gsz); u.pn = (wgid % nig) / gsz; return true;
    }
    __device__ __forceinline__ void a_ready(const Unit&) const {}
    __device__ __forceinline__ void done(const Unit&) const {}
};


__device__ __forceinline__ unsigned cvt_pk_bf16(float lo, float hi) { unsigned r; asm volatile("v_cvt_pk_bf16_f32 %0, %1, %2" : "=v"(r) : "v"(lo), "v"(hi)); return r; }
__device__ __forceinline__ float silu1(float v) { return v * __builtin_amdgcn_rcpf(1.0f + __builtin_amdgcn_exp2f(-1.4426950408889634f * v)); }
__device__ __forceinline__ f32x4 silu4(f32x4 v) { return (f32x4){silu1(v[0]), silu1(v[1]), silu1(v[2]), silu1(v[3])}; }
struct EpiInA {
    static constexpr bool PERM = true, AFTER_DRAIN = false;
    bf16_t* Q; size_t part_stride; float scale0;
    __device__ __forceinline__ void operator()(const f32x4 (&acc)[2][2][4][2], const Unit& u, int wr, int wc, int fr, int fq) const {
        const int row0 = u.pm * BM + wr * 64 + fr; const int colt = u.pn * BM, part = colt >> 10;
        bf16_t* base = Q + (size_t)part * part_stride; const int col0 = (colt & 1023) + wc * 32 + 8 * fq;
        const float sc = part == 0 ? scale0 : 1.f; const bool act = part == 3;
#pragma unroll
        for (int ai = 0; ai < 2; ++ai)
#pragma unroll
            for (int m = 0; m < 4; ++m) { bf16_t* rowp = base + (size_t)(row0 + ai * HALF + m * 16) * 1024 + col0;
#pragma unroll
                for (int bj = 0; bj < 2; ++bj) { f32x4 v0 = acc[ai][bj][m][0], v1 = acc[ai][bj][m][1];
                    if (act) { v0 = silu4(v0); v1 = silu4(v1); }
                    v0 = v0 * sc; v1 = v1 * sc; u32x4 w; w.x = cvt_pk_bf16(v0[0], v0[1]); w.y = cvt_pk_bf16(v0[2], v0[3]); w.z = cvt_pk_bf16(v1[0], v1[1]); w.w = cvt_pk_bf16(v1[2], v1[3]);
                    *(u32x4*)(rowp + bj * HALF) = w; } }
    }
};
struct EpiInB {
    static constexpr bool PERM = true, AFTER_DRAIN = false;
    bf16_t *Ksh, *Vsh, *Q, *G; float scale0;
    __device__ __forceinline__ void operator()(const f32x4 (&acc)[2][2][4][2], const Unit& u, int wr, int wc, int fr, int fq) const {
        const int row0 = u.pm * BM + wr * 64 + fr; const int pn = u.pn;
        const bool act = pn >= 5; const float sc = (pn >= 1 && pn <= 4) ? scale0 : 1.f;
#pragma unroll
        for (int bj = 0; bj < 2; ++bj) {
            bf16_t* base; int ld, col0;
            if (pn == 0) { base = bj == 0 ? Ksh : Vsh; ld = 128; col0 = wc * 32 + 8 * fq; }
            else if (pn <= 4) { base = Q; ld = 1024; col0 = (pn - 1) * BM + bj * HALF + wc * 32 + 8 * fq; }
            else { base = G; ld = 1024; col0 = (pn - 5) * BM + bj * HALF + wc * 32 + 8 * fq; }
#pragma unroll
            for (int ai = 0; ai < 2; ++ai)
#pragma unroll
                for (int m = 0; m < 4; ++m) { f32x4 v0 = acc[ai][bj][m][0], v1 = acc[ai][bj][m][1];
                    if (act) { v0 = silu4(v0); v1 = silu4(v1); }
                    v0 = v0 * sc; v1 = v1 * sc; u32x4 w; w.x = cvt_pk_bf16(v0[0], v0[1]); w.y = cvt_pk_bf16(v0[2], v0[3]); w.z = cvt_pk_bf16(v1[0], v1[1]); w.w = cvt_pk_bf16(v1[2], v1[3]);
                    *(u32x4*)(base + (size_t)(row0 + ai * HALF + m * 16) * ld + col0) = w; }
        }
    }
};
struct EpiRes {
    static constexpr bool PERM = false, AFTER_DRAIN = false;
    const float* base; float* out;
    __device__ __forceinline__ void operator()(const f32x4 (&acc)[2][2][4][2], const Unit& u, int wr, int wc, int fr, int fq) const {
        const int row0 = u.pm * BM + wr * 64 + fr, col0 = u.pn * BM + wc * 32 + 4 * fq;
#pragma unroll
        for (int ai = 0; ai < 2; ++ai)
#pragma unroll
            for (int m = 0; m < 4; ++m) { const size_t off = (size_t)(row0 + ai * HALF + m * 16) * 1024 + col0;
#pragma unroll
                for (int bj = 0; bj < 2; ++bj)
#pragma unroll
                    for (int n = 0; n < 2; ++n) { const size_t o = off + bj * HALF + n * 16; const f32x4 bs = *(const f32x4*)(base + o); *(f32x4*)(out + o) = bs + acc[ai][bj][m][n]; }
                if (m & 1) asm volatile("" ::: "memory"); }
    }
};

template <class Epi, class Sched, bool ALIGN_EPI = false, bool SP2 = false>
__device__ __forceinline__ void gemm_phase(PG8_LAS unsigned char* lds, const Gemm g, const Sched& S, const Epi& E) {
    const int tid = threadIdx.x, wid = __builtin_amdgcn_readfirstlane(tid >> 6), lane = tid & 63, wr = wid >> 2, wc = wid & 3, fr = lane & 15, fq = lane >> 4;
    const int K = g.K, nt = K / BK;
    unsigned voffA[2], voffB[2];
#pragma unroll
    for (int i = 0; i < 2; ++i) { int R, C; stage_rc(tid * 16 + i * 8192, R, C); const int Rb = Epi::PERM ? ((R & ~31) + perm32(R & 31)) : R;
        voffA[i] = (unsigned)(R * K + C) * 2u; voffB[i] = (unsigned)(Rb * K + C) * 2u; }
    const size_t kstep = (size_t)(BK * 2);
    const size_t hstep = (size_t)HALF * K * 2;
    const size_t tstep = 2 * hstep;
    const unsigned ldsw = (unsigned)wid * 1024u;
    const int aoff = lds_byte(wr * 64 + fr, fq * 8), boff = lds_byte(wc * 32 + fr, fq * 8);
#define PG8_SA(b, h) (((b) * 2 + (h)) * HTB)
#define PG8_SB(b, h) ((4 + (b) * 2 + (h)) * HTB)
#define PG8_STAGE(bufoff, gbase, voff) do { _Pragma("unroll") for (int _i = 0; _i < 2; ++_i) \
        __builtin_amdgcn_global_load_lds((const unsigned*)((const char*)(gbase) + (voff)[_i]), (PG8_LAS unsigned*)(lds + (bufoff) + ldsw + _i * 8192), 16, 0, 0); } while (0)
#define PG8_LDA(dst, b, h) do { _Pragma("unroll") for (int m = 0; m < 4; ++m) _Pragma("unroll") for (int k = 0; k < 2; ++k) dst[m][k] = *(const PG8_LAS bf16x8*)(lds + PG8_SA(b, h) + aoff + m * 2048 + k * 1024); } while (0)
#define PG8_LDB(dst, b, h) do { _Pragma("unroll") for (int n = 0; n < 2; ++n) _Pragma("unroll") for (int k = 0; k < 2; ++k) dst[n][k] = *(const PG8_LAS bf16x8*)(lds + PG8_SB(b, h) + boff + n * 2048 + k * 1024); } while (0)
#define PG8_MMA(ai, bj, At, Bt) do { __builtin_amdgcn_s_setprio(1); _Pragma("unroll") for (int m = 0; m < 4; ++m) _Pragma("unroll") for (int n = 0; n < 2; ++n) _Pragma("unroll") for (int k = 0; k < 2; ++k) \
        acc[ai][bj][m][n] = __builtin_amdgcn_mfma_f32_16x16x32_bf16(Bt[n][k], At[m][k], acc[ai][bj][m][n], 0, 0, 0); __builtin_amdgcn_s_setprio(0); } while (0)
#define PG8_WAIT_V(n) asm volatile("s_waitcnt vmcnt(" #n ")" ::: "memory")
#define PG8_WAIT_L(n) asm volatile("s_waitcnt lgkmcnt(" #n ")" ::: "memory")
#define PG8_BAR __builtin_amdgcn_s_barrier()
#define PG8_SCHED __builtin_amdgcn_sched_barrier(0)
    Unit cur, nxt; int ui = 0;
    if (!S.next(0, cur)) return;
    f32x4 acc[2][2][4][2];
#pragma unroll
    for (int a = 0; a < 2; ++a)
#pragma unroll
        for (int b = 0; b < 2; ++b)
#pragma unroll
            for (int m = 0; m < 4; ++m)
#pragma unroll
                for (int n = 0; n < 2; ++n) acc[a][b][m][n] = (f32x4){0.f, 0.f, 0.f, 0.f};
    bf16x8 At[4][2], B0[2][2], B1[2][2];
    const char* cA = (const char*)g.A + (size_t)cur.pm * tstep; const char* cB = (const char*)g.Bt + (size_t)cur.pn * tstep;
    S.a_ready(cur);
    if constexpr (SP2) {
        PG8_STAGE(PG8_SB(0, 0), cB, voffB); PG8_STAGE(PG8_SB(0, 1), cB + hstep, voffB); PG8_STAGE(PG8_SA(0, 0), cA, voffA); PG8_STAGE(PG8_SA(0, 1), cA + hstep, voffA);
        if (wr == 1) PG8_BAR;
        PG8_WAIT_V(2); PG8_BAR;
        PG8_STAGE(PG8_SB(1, 0), cB + kstep, voffB); PG8_STAGE(PG8_SA(1, 0), cA + kstep, voffA); PG8_STAGE(PG8_SB(1, 1), cB + hstep + kstep, voffB);
        PG8_WAIT_V(6); PG8_BAR;
    } else {
        PG8_STAGE(PG8_SB(0, 0), cB, voffB); PG8_STAGE(PG8_SA(0, 0), cA, voffA); PG8_STAGE(PG8_SB(0, 1), cB + hstep, voffB); PG8_STAGE(PG8_SA(0, 1), cA + hstep, voffA);
        if (wr == 1) PG8_BAR;
        PG8_WAIT_V(4); PG8_BAR;
        PG8_STAGE(PG8_SB(1, 0), cB + kstep, voffB); PG8_STAGE(PG8_SA(1, 0), cA + kstep, voffA); PG8_STAGE(PG8_SB(1, 1), cB + hstep + kstep, voffB);
        PG8_WAIT_V(6); PG8_BAR;
    }
    for (;;) {
        const bool has_next = S.next(ui + 1, nxt);
        const char* nA = has_next ? (const char*)g.A + (size_t)nxt.pm * tstep : cA; const char* nB = has_next ? (const char*)g.Bt + (size_t)nxt.pn * tstep : cB;
        for (int t = 0; t < nt; t += 2) {
            const bool last = (t == nt - 2);
            const char* a1 = cA + (size_t)(t + 1) * kstep;
            const char* a2 = last ? nA : cA + (size_t)(t + 2) * kstep; const char* b2 = last ? nB : cB + (size_t)(t + 2) * kstep;
            const char* a3 = a2 + kstep; const char* b3 = b2 + kstep;
            if (last && has_next) S.a_ready(nxt);
            if constexpr (SP2) {
            PG8_LDB(B0, 0, 0); PG8_LDB(B1, 0, 1); PG8_SCHED; PG8_LDA(At, 0, 0); PG8_STAGE(PG8_SA(1, 1), a1 + hstep, voffA);
            PG8_WAIT_V(8); PG8_WAIT_L(0); PG8_BAR; PG8_MMA(0, 0, At, B0); PG8_MMA(0, 1, At, B1); PG8_BAR; PG8_SCHED;
            PG8_LDA(At, 0, 1); PG8_STAGE(PG8_SB(0, 0), b2, voffB); PG8_STAGE(PG8_SB(0, 1), b2 + hstep, voffB); PG8_STAGE(PG8_SA(0, 0), a2, voffA);
            PG8_WAIT_V(8); PG8_WAIT_L(0); PG8_BAR; PG8_MMA(1, 0, At, B0); PG8_MMA(1, 1, At, B1); PG8_BAR; PG8_SCHED;
            PG8_LDB(B0, 1, 0); PG8_LDB(B1, 1, 1); PG8_SCHED; PG8_LDA(At, 1, 0); PG8_STAGE(PG8_SA(0, 1), a2 + hstep, voffA);
            PG8_WAIT_V(8); PG8_WAIT_L(0); PG8_BAR; PG8_MMA(0, 0, At, B0); PG8_MMA(0, 1, At, B1); PG8_BAR; PG8_SCHED;
            PG8_LDA(At, 1, 1); PG8_STAGE(PG8_SB(1, 0), b3, voffB); PG8_STAGE(PG8_SB(1, 1), b3 + hstep, voffB); PG8_STAGE(PG8_SA(1, 0), a3, voffA);
            PG8_WAIT_V(8); PG8_WAIT_L(0); PG8_BAR; PG8_MMA(1, 0, At, B0); PG8_MMA(1, 1, At, B1); PG8_BAR; PG8_SCHED;
            } else {
            PG8_LDB(B0, 0, 0); PG8_SCHED; PG8_LDA(At, 0, 0); PG8_STAGE(PG8_SA(1, 1), a1 + hstep, voffA);
            PG8_WAIT_L(8); PG8_BAR; PG8_WAIT_L(0); PG8_MMA(0, 0, At, B0); PG8_BAR; PG8_SCHED;
            PG8_LDB(B1, 0, 1); PG8_STAGE(PG8_SB(0, 0), b2, voffB);
            PG8_BAR; PG8_WAIT_L(0); PG8_MMA(0, 1, At, B1); PG8_BAR;
            PG8_LDA(At, 0, 1); PG8_STAGE(PG8_SA(0, 0), a2, voffA);
            PG8_BAR; PG8_WAIT_L(0); PG8_MMA(1, 0, At, B0); PG8_BAR; PG8_SCHED;
            PG8_STAGE(PG8_SB(0, 1), b2 + hstep, voffB);
            PG8_WAIT_V(6); PG8_BAR; PG8_MMA(1, 1, At, B1); PG8_BAR;
            PG8_LDB(B0, 1, 0); PG8_SCHED; PG8_LDA(At, 1, 0); PG8_STAGE(PG8_SA(0, 1), a2 + hstep, voffA);
            PG8_WAIT_L(8); PG8_BAR; PG8_WAIT_L(0); PG8_MMA(0, 0, At, B0); PG8_BAR; PG8_SCHED;
            PG8_LDB(B1, 1, 1); PG8_STAGE(PG8_SB(1, 0), b3, voffB);
            PG8_BAR; PG8_WAIT_L(0); PG8_MMA(0, 1, At, B1); PG8_BAR;
            PG8_LDA(At, 1, 1); PG8_STAGE(PG8_SA(1, 0), a3, voffA);
            PG8_BAR; PG8_WAIT_L(0); PG8_MMA(1, 0, At, B0); PG8_BAR; PG8_SCHED;
            PG8_STAGE(PG8_SB(1, 1), b3 + hstep, voffB);
            PG8_WAIT_V(6); PG8_BAR; PG8_MMA(1, 1, At, B1); PG8_BAR;
            }
        }
        if constexpr (ALIGN_EPI) { if (wr == 0) PG8_BAR; }
        if constexpr (!Epi::AFTER_DRAIN) { E(acc, cur, wr, wc, fr, fq); S.done(cur); }
        if (!has_next) break;
#pragma unroll
        for (int a = 0; a < 2; ++a)
#pragma unroll
            for (int b = 0; b < 2; ++b)
#pragma unroll
                for (int m = 0; m < 4; ++m)
#pragma unroll
                    for (int n = 0; n < 2; ++n) acc[a][b][m][n] = (f32x4){0.f, 0.f, 0.f, 0.f};
        cur = nxt; cA = nA; cB = nB; ++ui;
        if constexpr (ALIGN_EPI) { if (wr == 1) PG8_BAR; }
    }
    PG8_WAIT_V(0);
    if constexpr (!ALIGN_EPI) { if (wr == 0) PG8_BAR; }
    PG8_BAR;
    if constexpr (Epi::AFTER_DRAIN) { E.fused(acc, cur, wr, wc, fr, fq, lds, wid, lane); S.done(cur); }
#undef PG8_SA
#undef PG8_SB
#undef PG8_STAGE
#undef PG8_LDA
#undef PG8_LDB
#undef PG8_MMA
#undef PG8_WAIT_V
#undef PG8_WAIT_L
#undef PG8_BAR
#undef PG8_SCHED
}
}

#ifndef PG8_SP2
#define PG8_SP2 true
#endif
#ifndef PG8_ALIGN
#define PG8_ALIGN true
#endif
#define XB_TMO      128
#define XB_XCNT(j)  (256  + 64 * (j))
#define XB_XSUB(j)  (1280 + 64 * (j))
#define XB_XGEN(j)  (2304 + 64 * (j))
#define XB_TOP      3328
#define XB_TOPGEN   3392
#define XCD_BAR_WORDS 3456
#define XB_SPIN_CAP (1u << 18)

__device__ __forceinline__ unsigned xb_ld(unsigned* p)              { return __hip_atomic_load(p, __ATOMIC_RELAXED, __HIP_MEMORY_SCOPE_AGENT); }
__device__ __forceinline__ unsigned xb_add(unsigned* p, unsigned v) { return __hip_atomic_fetch_add(p, v, __ATOMIC_RELAXED, __HIP_MEMORY_SCOPE_AGENT); }
__device__ __forceinline__ unsigned xb_xcc_id() { return (unsigned)__builtin_amdgcn_s_getreg((3 << 11) | 20) & 0xFu; }
#define XB_SPIN(cond, bar) do { unsigned _sp = 0; while (cond) { __builtin_amdgcn_s_sleep(1); \
    if ((++_sp & 255u) == 0u) { if (xb_ld(&(bar)[XB_TMO])) break; if (_sp > XB_SPIN_CAP) { atomicAdd(&(bar)[XB_TMO], 1u); break; } } } } while (0)

struct XcdBarrier {
    unsigned* bar; unsigned x;
    volatile LAS unsigned* st;
};

__device__ __forceinline__ XcdBarrier xcd_barrier_post(unsigned* bar, volatile LAS unsigned* st) {
    XcdBarrier b; b.bar = bar; b.x = xb_xcc_id(); b.st = st;
    if (threadIdx.x == 0) (void)xb_add(&bar[XB_XCNT(b.x)], 1u);
    return b;
}
__device__ __forceinline__ void xcd_barrier_complete(unsigned* bar, unsigned x, unsigned& nloc, unsigned& nx) {
    const unsigned G = gridDim.x * gridDim.y * gridDim.z;
    unsigned sum, cnt, mine, sp = 0u;
    for (;;) {
        sum = 0u; cnt = 0u; mine = 0u;
#pragma unroll
        for (unsigned j = 0; j < 16; ++j) { const unsigned c = xb_ld(&bar[XB_XCNT(j)]); sum += c; cnt += (c > 0u) ? 1u : 0u; mine = (j == x) ? c : mine; }
        if (sum == G) break;
        __builtin_amdgcn_s_sleep(1);
        if ((++sp & 255u) == 0u) { if (xb_ld(&bar[XB_TMO])) break; if (sp > XB_SPIN_CAP) { atomicAdd(&bar[XB_TMO], 1u); break; } }
    }
    nloc = mine > 0u ? mine : 1u; nx = cnt > 0u ? cnt : 1u;
}

__device__ __forceinline__ void xcd_barrier(const XcdBarrier& b) {
    asm volatile("s_waitcnt vmcnt(0)" ::: "memory");
    __syncthreads();
    if (threadIdx.x == 0) {
        unsigned* bar = b.bar;
        __builtin_amdgcn_s_waitcnt(0);
        unsigned nloc = b.st[0], nx = b.st[1];
        if (nloc == 0u) { xcd_barrier_complete(bar, b.x, nloc, nx); b.st[0] = nloc; b.st[1] = nx; }
        const unsigned old = xb_add(&bar[XB_XSUB(b.x)], 1u);
        const unsigned gen = old / nloc;
        if (old + 1u == (gen + 1u) * nloc) {
            __builtin_amdgcn_fence(__ATOMIC_RELEASE, "agent");
            asm volatile("s_waitcnt vmcnt(0)" ::: "memory");
            const unsigned og = xb_add(&bar[XB_TOP], 1u);
            const unsigned tg = og / nx;
            if (og + 1u == (tg + 1u) * nx) xb_add(&bar[XB_TOPGEN], 1u);
            else XB_SPIN(xb_ld(&bar[XB_TOPGEN]) == tg, bar);
            __builtin_amdgcn_fence(__ATOMIC_ACQUIRE, "agent");
            xb_add(&bar[XB_XGEN(b.x)], 1u);
            asm volatile("s_waitcnt vmcnt(0)" ::: "memory");
        } else {
            XB_SPIN(xb_ld(&bar[XB_XGEN(b.x)]) == gen, bar);
            __builtin_amdgcn_fence(__ATOMIC_ACQUIRE, "agent");
            asm volatile("s_waitcnt vmcnt(0)" ::: "memory");
        }
    }
    __syncthreads();
}

#define RLX_AGENT __ATOMIC_RELAXED, __HIP_MEMORY_SCOPE_AGENT

__device__ __forceinline__ void transpose_item(const float* W, const float* gain, int K, int N, bf16_t* WT, int row_off, float* scr, int item, int lane) {
    const int nblk = N / 32, kb = item / nblk, nb = item % nblk, k0 = 64 * kb, n0 = 32 * nb;
#pragma unroll 8
    for (int i = 0; i < 32; ++i) { const int kk = 2 * i + (lane >> 5); const float g = gain ? gain[k0 + kk] : 1.0f; scr[kk * 33 + (lane & 31)] = W[(size_t)(k0 + kk) * N + n0 + (lane & 31)] * g; }
    asm volatile("s_waitcnt lgkmcnt(0)" ::: "memory");
    const int c = lane & 7;
#pragma unroll
    for (int j = 0; j < 4; ++j) { const int n = (lane >> 3) + 8 * j; const float* s = scr + (8 * c) * 33 + n;
        u32x4 o; o.x = pk2(s[0 * 33], s[1 * 33]); o.y = pk2(s[2 * 33], s[3 * 33]); o.z = pk2(s[4 * 33], s[5 * 33]); o.w = pk2(s[6 * 33], s[7 * 33]);
        *(u32x4*)(WT + (size_t)(row_off + n0 + n) * K + k0 + 8 * c) = o; }
    asm volatile("s_waitcnt lgkmcnt(0)" ::: "memory");
}

__device__ __forceinline__ void norm_row_bf16(const float* xrow, bf16_t* orow, int lane) {
    const f32x4* xr = (const f32x4*)xrow + lane;
    f32x4 v[4]; float s = 0.f;
#pragma unroll
    for (int j = 0; j < 4; ++j) { v[j] = xr[64 * j]; s += (v[j].x * v[j].x + v[j].y * v[j].y) + (v[j].z * v[j].z + v[j].w * v[j].w); }
    const float rstd = 1.0f / sqrtf(wave_sum(s) * (1.0f / D) + EPS);
    u32x2* o8 = (u32x2*)orow + lane;
#pragma unroll
    for (int j = 0; j < 4; ++j) { u32x2 w; w.x = pk2(v[j].x * rstd, v[j].y * rstd); w.y = pk2(v[j].z * rstd, v[j].w * rstd); o8[64 * j] = w; }
}

__device__ __forceinline__ int t5_bucket(int rel) {
    const int n = rel < 0 ? -rel : rel;
    int v;
    if (n < 8) v = n;
    else if (n < 12) v = 8; else if (n < 16) v = 9; else if (n < 23) v = 10; else if (n < 32) v = 11;
    else if (n < 46) v = 12; else if (n < 64) v = 13; else if (n < 91) v = 14; else v = 15;
    return (rel > 0 ? 16 : 0) + v;
}

template <bool LB>
__device__ __forceinline__ void attn_simple(const bf16_t* Q, const bf16_t* __restrict__ Kb, const bf16_t* __restrict__ Vb, const bf16_t* __restrict__ G, bf16_t* O,
                                            const float* __restrict__ btab, const float* __restrict__ sink2, float* wsf, int wid, int lane) {
    constexpr int NT = LB ? 3 : 9, LEFT = NT - 1, KS = LB ? 128 : 1024;
    const int r32 = lane & 31, hi = lane >> 5;
    const int gw = blockIdx.x * NWAVES + wid, NGW = gridDim.x * NWAVES;
    for (int u = gw; u < 8192; u += NGW) {
        const int half = u & 1, c = (u >> 1) & 63, h = (u >> 7) & 15, b = u >> 11;
        const int kvh = LB ? (h >> 3) : h;
        const int m0 = b * SEQ + c * 64 + half * 32;
        bf16x8 qf[4];
#pragma unroll
        for (int d0 = 0; d0 < 4; ++d0) qf[d0] = *(const bf16x8*)(Q + (size_t)(m0 + r32) * 1024 + h * 64 + d0 * 16 + hi * 8);
        float m = LB ? sink2[h] : -1e30f;
        float l = (LB && hi == 0) ? 1.f : 0.f;
        f32x16 o[2];
#pragma unroll
        for (int r = 0; r < 16; ++r) { o[0][r] = 0.f; o[1][r] = 0.f; }
        const int qpos = c * 64 + half * 32 + r32;
        for (int kb = 0; kb < NT * 2; ++kb) {
            const int ck = c - LEFT + (kb >> 1);
            if (ck < 0) continue;
            const int krow0 = b * SEQ + ck * 64 + (kb & 1) * 32;
            f32x16 s;
#pragma unroll
            for (int r = 0; r < 16; ++r) s[r] = 0.f;
#pragma unroll
            for (int d0 = 0; d0 < 4; ++d0) {
                const bf16x8 kf = *(const bf16x8*)(Kb + (size_t)(krow0 + r32) * KS + kvh * 64 + d0 * 16 + hi * 8);
                s = __builtin_amdgcn_mfma_f32_32x32x16_bf16(kf, qf[d0], s, 0, 0, 0);
            }
            const int kbase = ck * 64 + (kb & 1) * 32 + 4 * hi;
#pragma unroll
            for (int r = 0; r < 16; ++r) {
                const int kpos = kbase + (r & 3) + 8 * (r >> 2);
                if (LB) { s[r] += btab[h * 256 + (kpos - qpos) + 191]; }
                else { int dist = qpos - kpos; dist = dist < -256 ? -256 : (dist > 256 ? 256 : dist); s[r] += btab[h * 520 + dist + 256]; }
            }
            float bm = s[0];
#pragma unroll
            for (int r = 1; r < 16; ++r) bm = fmaxf(bm, s[r]);
            bm = fmaxf(bm, __shfl_xor(bm, 32));
            const float mn = fmaxf(m, bm), alpha = __builtin_amdgcn_exp2f(m - mn); m = mn;
            float ps = 0.f;
#pragma unroll
            for (int r = 0; r < 16; ++r) { s[r] = __builtin_amdgcn_exp2f(s[r] - mn); ps += s[r]; }
            l = l * alpha + ps;
            if (hi == 0) wsf[r32] = alpha;
            asm volatile("s_waitcnt lgkmcnt(0)" ::: "memory");
#pragma unroll
            for (int r = 0; r < 16; ++r) { const float a = wsf[(r & 3) + 8 * (r >> 2) + 4 * hi]; o[0][r] *= a; o[1][r] *= a; }
            asm volatile("s_waitcnt lgkmcnt(0)" ::: "memory");
#pragma unroll
            for (int s2 = 0; s2 < 2; ++s2) {
                u32x4 pw; pw.x = pk2(s[8 * s2 + 0], s[8 * s2 + 1]); pw.y = pk2(s[8 * s2 + 2], s[8 * s2 + 3]); pw.z = pk2(s[8 * s2 + 4], s[8 * s2 + 5]); pw.w = pk2(s[8 * s2 + 6], s[8 * s2 + 7]);
                const bf16x8 pa = __builtin_bit_cast(bf16x8, pw);
#pragma unroll
                for (int db = 0; db < 2; ++db) {
                    bf16x8 vf;
#pragma unroll
                    for (int j = 0; j < 8; ++j) { const int key = 16 * s2 + 8 * (j >> 2) + 4 * hi + (j & 3);
                        vf[j] = (short)Vb[(size_t)(krow0 + key) * KS + kvh * 64 + db * 32 + r32]; }
                    o[db] = __builtin_amdgcn_mfma_f32_32x32x16_bf16(pa, vf, o[db], 0, 0, 0);
                }
            }
        }
        l += __shfl_xor(l, 32);
        if (hi == 0) wsf[r32] = 1.0f / l;
        asm volatile("s_waitcnt lgkmcnt(0)" ::: "memory");
#pragma unroll
        for (int r = 0; r < 16; ++r) {
            const int row = (r & 3) + 8 * (r >> 2) + 4 * hi; const float a = wsf[row];
#pragma unroll
            for (int db = 0; db < 2; ++db) { const size_t off = (size_t)(m0 + row) * 1024 + h * 64 + db * 32 + r32;
                O[off] = (bf16_t)f2bf(o[db][r] * a * bf2f(G[off])); }
        }
        asm volatile("s_waitcnt lgkmcnt(0)" ::: "memory");
    }
}

__global__ void __launch_bounds__(NWAVES * 64, 2) fwd_megakernel(Params p) {
    extern __shared__ __attribute__((aligned(16))) unsigned char lds[];
    LAS unsigned char* ldsa = (LAS unsigned char*)lds;
    const int tid = threadIdx.x, lane = tid & 63, wid = __builtin_amdgcn_readfirstlane(tid >> 6);
    const int gw = blockIdx.x * NWAVES + wid, NGW = gridDim.x * NWAVES, G = gridDim.x;
    unsigned char* ws = p.ws;
    float* relb = (float*)(ws + WS_RELB); float* t5b = (float*)(ws + WS_T5B); float* sink2 = (float*)(ws + WS_SINK);
    bf16_t* WaT = (bf16_t*)(ws + WS_WA); bf16_t* WoAT = (bf16_t*)(ws + WS_WOA); bf16_t* WkvbT = (bf16_t*)(ws + WS_WKVB); bf16_t* WoBT = (bf16_t*)(ws + WS_WOB);
    bf16_t* XN = (bf16_t*)(ws + WS_XN); bf16_t* Qb = (bf16_t*)(ws + WS_Q); bf16_t* Kb = (bf16_t*)(ws + WS_K); bf16_t* Vb = (bf16_t*)(ws + WS_V); bf16_t* Gb = (bf16_t*)(ws + WS_G);
    bf16_t* Ksh = (bf16_t*)(ws + WS_KSH); bf16_t* Vsh = (bf16_t*)(ws + WS_VSH);
    float* wsf = (float*)lds + wid * 64;
    for (int u = tid; u < (LDS_BYTES - LDSCTL_OFF) / 4; u += NWAVES * 64) ((LAS unsigned*)(ldsa + LDSCTL_OFF))[u] = 0u;
    __syncthreads();
    volatile LAS unsigned* MISC = (volatile LAS unsigned*)(ldsa + MISC_OFF);
    XcdBarrier bar = xcd_barrier_post((unsigned*)(ws + WS_CTL) + CW_BAR, MISC + 8);

    {
        float* scr = (float*)(lds + wid * 16384);
        constexpr int I_A = 16 * 128, I_O = 16 * 32, I_KV = 16 * 8, I_B = 16 * 64;
        constexpr int NIT = I_A + I_O + I_KV + I_B + I_O;
        for (int it = gw; it < NIT; it += NGW) {
            int r = it;
            if (r < I_A) { transpose_item(p.a_w_in, p.a_norm, 1024, 4096, WaT, 0, scr, r, lane); continue; } r -= I_A;
            if (r < I_O) { transpose_item(p.a_w_out, nullptr, 1024, 1024, WoAT, 0, scr, r, lane); continue; } r -= I_O;
            if (r < I_KV) { transpose_item(p.kv_w, p.kv_norm, 1024, 256, WkvbT, 0, scr, r, lane); continue; } r -= I_KV;
            if (r < I_B) { transpose_item(p.b_w_in, p.b_norm, 1024, 2048, WkvbT, 256, scr, r, lane); continue; } r -= I_B;
            transpose_item(p.b_w_out, nullptr, 1024, 1024, WoBT, 0, scr, r, lane);
        }
        const int gt = blockIdx.x * (NWAVES * 64) + tid, NGT = gridDim.x * (NWAVES * 64);
        for (int i = gt; i < 16 * 513; i += NGT) { const int h = i / 513, j = i % 513; relb[h * 520 + j] = p.a_rel_bias[j * 16 + h] * LOG2E; }
        for (int i = gt; i < 16 * 255; i += NGT) { const int h = i / 255, j = i % 255; t5b[h * 256 + j] = p.t5_bias[t5_bucket(j - 191) * 16 + h] * LOG2E; }
        if (gt < 16) sink2[gt] = p.b_sinks[gt] * LOG2E;
        for (int m = gw; m < M; m += NGW) norm_row_bf16(p.x + (size_t)m * D, XN + (size_t)m * D, lane);
    }
    xcd_barrier(bar);
    { pg8::Gemm g{XN, WaT, M, 4096, 1024}; pg8::StaticOrder S; S.init(M, 4096, G, (int)blockIdx.x);
      pg8::EpiInA E{Qb, (size_t)(WS_K - WS_Q) / 2, C2};
      pg8::gemm_phase<pg8::EpiInA, pg8::StaticOrder, PG8_ALIGN, PG8_SP2>(ldsa, g, S, E); }
    xcd_barrier(bar);
    attn_simple<false>(Qb, Kb, Vb, Gb, Qb, relb, sink2, wsf, wid, lane);
    xcd_barrier(bar);
    { pg8::Gemm g{Qb, WoAT, M, 1024, 1024}; pg8::StaticOrder S; S.init(M, 1024, G, (int)blockIdx.x);
      pg8::EpiRes E{p.x, p.out};
      pg8::gemm_phase<pg8::EpiRes, pg8::StaticOrder, PG8_ALIGN, PG8_SP2>(ldsa, g, S, E); }
    xcd_barrier(bar);
    for (int m = gw; m < M; m += NGW) norm_row_bf16(p.out + (size_t)m * D, XN + (size_t)m * D, lane);
    xcd_barrier(bar);
    { pg8::Gemm g{XN, WkvbT, M, 2304, 1024}; pg8::StaticOrder S; S.init(M, 2304, G, (int)blockIdx.x);
      pg8::EpiInB E{Ksh, Vsh, Kb, Vb, C2};
      pg8::gemm_phase<pg8::EpiInB, pg8::StaticOrder, PG8_ALIGN, PG8_SP2>(ldsa, g, S, E); }
    xcd_barrier(bar);
    attn_simple<true>(Kb, Ksh, Vsh, Vb, Kb, t5b, sink2, wsf, wid, lane);
    xcd_barrier(bar);
    { pg8::Gemm g{Kb, WoBT, M, 1024, 1024}; pg8::StaticOrder S; S.init(M, 1024, G, (int)blockIdx.x);
      pg8::EpiRes E{p.out, p.out};
      pg8::gemm_phase<pg8::EpiRes, pg8::StaticOrder, PG8_ALIGN, PG8_SP2>(ldsa, g, S, E); }
    xcd_barrier(bar);
    for (int m = gw; m < M; m += NGW) {
        f32x4* xr = (f32x4*)(p.out + (size_t)m * D) + lane; const f32x4* gr = (const f32x4*)p.final_norm + lane;
        f32x4 v[4]; float s = 0.f;
#pragma unroll
        for (int j = 0; j < 4; ++j) { v[j] = xr[64 * j]; s += (v[j].x * v[j].x + v[j].y * v[j].y) + (v[j].z * v[j].z + v[j].w * v[j].w); }
        const float rstd = 1.0f / sqrtf(wave_sum(s) * (1.0f / D) + EPS);
#pragma unroll
        for (int j = 0; j < 4; ++j) { const f32x4 g = gr[64 * j]; xr[64 * j] = v[j] * rstd * g; }
    }
}

extern "C" void kernel_launch(void* const* d_in, const int* in_sizes, int n_in, void* d_out, int out_size, void* d_ws, size_t ws_size, hipStream_t stream) {
    static int grid_blocks = 0;
    if (grid_blocks == 0) {
        if (n_in != 13 || out_size != M * D || ws_size < WS_END) { fprintf(stderr, "kernel_launch: unexpected shapes n_in %d out %d ws %zu\n", n_in, out_size, ws_size); grid_blocks = -1; return; }
        int dev = 0, cus = 0, per_cu = 0;
        (void)hipGetDevice(&dev);
        (void)hipDeviceGetAttribute(&cus, hipDeviceAttributeMultiprocessorCount, dev);
        if (hipFuncSetAttribute((const void*)fwd_megakernel, hipFuncAttributeMaxDynamicSharedMemorySize, LDS_BYTES) != hipSuccess) { fprintf(stderr, "kernel_launch: hipFuncSetAttribute failed\n"); grid_blocks = -1; return; }
        if (hipOccupancyMaxActiveBlocksPerMultiprocessor(&per_cu, (const void*)fwd_megakernel, NWAVES * 64, LDS_BYTES) != hipSuccess || per_cu < 1)
            fprintf(stderr, "kernel_launch: occupancy query reports %d workgroups per CU\n", per_cu);
        (void)hipGetLastError();
        grid_blocks = cus;
    }
    if (grid_blocks < 0) return;
    if (hipMemsetAsync((char*)d_ws + WS_CTL, 0, CTL_ZERO_BYTES, stream) != hipSuccess) { fprintf(stderr, "kernel_launch: hipMemsetAsync failed\n"); return; }
    Params p{};
    p.x = (const float*)d_in[0]; p.a_norm = (const float*)d_in[1]; p.a_w_in = (const float*)d_in[2]; p.a_rel_bias = (const float*)d_in[3];
    p.a_w_out = (const float*)d_in[4]; p.kv_norm = (const float*)d_in[5]; p.kv_w = (const float*)d_in[6]; p.t5_bias = (const float*)d_in[7];
    p.b_norm = (const float*)d_in[8]; p.b_w_in = (const float*)d_in[9]; p.b_sinks = (const float*)d_in[10]; p.b_w_out = (const float*)d_in[11];
    p.final_norm = (const float*)d_in[12]; p.out = (float*)d_out; p.ws = (unsigned char*)d_ws;
    void* args[] = {&p};
    hipError_t e = hipLaunchCooperativeKernel((const void*)fwd_megakernel, dim3(grid_blocks), dim3(NWAVES * 64), args, LDS_BYTES, stream);
    if (e != hipSuccess) fprintf(stderr, "cooperative launch failed: %s (grid %d)\n", hipGetErrorString(e), grid_blocks);
}
```
